# Optimizing an MI355X kernel written in HIP

```python
import jax, jax.numpy as jnp
from jax import lax
import numpy as np

D_MODEL = 2048
BATCH = 16
SEQ = 256
DEPTH = 4
DEC_BATCH = 4
DEC_SEQ = 1024
PAST_LEN = 512

GRID_W = 64
HEAD_DIM = 128
N_Q_HEADS = 8
N_KV_HEADS = 2
Q_PER_KV = N_Q_HEADS // N_KV_HEADS
ATTN_WIDTH = N_Q_HEADS * HEAD_DIM
KV_WIDTH = N_KV_HEADS * HEAD_DIM
CONV_WIDTH = D_MODEL - ATTN_WIDTH
MIX_WIDTH = ATTN_WIDTH + CONV_WIDTH
IN_COLS = ATTN_WIDTH + 2 * KV_WIDTH + 2 * CONV_WIDTH
CONV_KERNEL = 31
CONV_PAD = CONV_KERNEL // 2
D_FF = 4 * D_MODEL
N_MOD = 6
Q_BLOCK = 128
ROPE_THETA = 10000.0
EPS = 1e-6

kernel_name = 'hybrid_gqa_conformer_diffusion_step'


def rms_norm(x, g):
    xf = x.astype(jnp.float32)
    y = xf * lax.rsqrt(jnp.mean(xf * xf, axis=-1, keepdims=True) + EPS)
    return (y * g.astype(jnp.float32)).astype(x.dtype)


def layer_norm(x, g, b):
    xf = x.astype(jnp.float32)
    mu = jnp.mean(xf, axis=-1, keepdims=True)
    xc = xf - mu
    y = xc * lax.rsqrt(jnp.mean(xc * xc, axis=-1, keepdims=True) + EPS)
    return (y * g.astype(jnp.float32) + b.astype(jnp.float32)).astype(x.dtype)


def grid_rotary(n_tokens):
    n_rows = n_tokens // GRID_W
    row = jnp.repeat(jnp.arange(n_rows, dtype=jnp.int32), GRID_W).astype(jnp.float32)
    col = jnp.tile(jnp.arange(GRID_W, dtype=jnp.int32), n_rows).astype(jnp.float32)
    n_pairs_axis = HEAD_DIM // 4
    freqs = ROPE_THETA ** (-jnp.arange(n_pairs_axis, dtype=jnp.float32) / n_pairs_axis)
    ang = jnp.concatenate([row[:, None] * freqs, col[:, None] * freqs], axis=-1)
    return jnp.cos(ang), jnp.sin(ang)


def apply_rotary(x, cos, sin):
    xf = x.astype(jnp.float32)
    half = HEAD_DIM // 2
    x1, x2 = xf[..., :half], xf[..., half:]
    cb, sb = cos[None, :, None, :], sin[None, :, None, :]
    return jnp.concatenate([x1 * cb - x2 * sb, x2 * cb + x1 * sb], axis=-1).astype(x.dtype)


def block_attention(q, k, v):
    b, tq = q.shape[0], q.shape[1]
    nb = tq // Q_BLOCK
    qb = q.reshape(b, nb, Q_BLOCK, N_KV_HEADS, Q_PER_KV, HEAD_DIM).transpose(1, 0, 2, 3, 4, 5)
    scale = HEAD_DIM ** -0.5

    def one_block(q_blk):
        s = jnp.einsum('bqkgd,bskd->bkgqs', q_blk, k).astype(jnp.float32) * scale
        p = jax.nn.softmax(s, axis=-1).astype(v.dtype)
        return jnp.einsum('bkgqs,bskd->bqkgd', p, v)

    o = lax.map(one_block, qb)
    return o.transpose(1, 0, 2, 3, 4, 5).reshape(b, tq, ATTN_WIDTH)


def depthwise_conv(u, w, bias):
    y = lax.conv_general_dilated(u, w[:, None, :], window_strides=(1,), padding=[(CONV_PAD, CONV_PAD)],
                                 dimension_numbers=('NWC', 'WIO', 'NWC'), feature_group_count=CONV_WIDTH)
    return y + bias


def trunk_layer(x, cond, rotary, ctx_k, ctx_v,
                norm1_g, w_mod, b_mod, w_in, q_norm_g, k_norm_g, conv_w, conv_b,
                conv_norm_g, conv_norm_b, w_out, norm2_g, w_ff1, w_ff2):
    b, t = x.shape[0], x.shape[1]
    mod = jax.nn.silu(cond) @ w_mod + b_mod
    shift1, scale1, gate1, shift2, scale2, gate2 = [m[:, None, :] for m in jnp.split(mod, N_MOD, axis=-1)]

    h = rms_norm(x, norm1_g) * (1 + scale1) + shift1
    proj = h @ w_in
    q, k, v, u = jnp.split(proj, [ATTN_WIDTH, ATTN_WIDTH + KV_WIDTH, ATTN_WIDTH + 2 * KV_WIDTH], axis=-1)
    q = rms_norm(q.reshape(b, t, N_Q_HEADS, HEAD_DIM), q_norm_g)
    k = rms_norm(k.reshape(b, t, N_KV_HEADS, HEAD_DIM), k_norm_g)
    v = v.reshape(b, t, N_KV_HEADS, HEAD_DIM)

    if rotary is None:
        attn = block_attention(q, k, v)
    else:
        cos, sin = rotary
        q_r = apply_rotary(q, cos, sin)
        k_r = apply_rotary(k, cos, sin)
        keys = jnp.concatenate([k_r, ctx_k], axis=1)
        vals = jnp.concatenate([v, ctx_v], axis=1)
        attn = block_attention(q_r, keys, vals)

    glu = u[..., :CONV_WIDTH] * jax.nn.sigmoid(u[..., CONV_WIDTH:])
    cv = jax.nn.silu(layer_norm(depthwise_conv(glu, conv_w, conv_b), conv_norm_g, conv_norm_b))

    mix = jnp.concatenate([attn, cv], axis=-1) @ w_out
    x = x + gate1 * mix

    h2 = rms_norm(x, norm2_g) * (1 + scale2) + shift2
    ff = jnp.square(jax.nn.relu(h2 @ w_ff1)) @ w_ff2
    x = x + gate2 * ff
    return x, k, v


def setup_inputs(seed: int = 0) -> dict:
    key = jax.random.key(seed)
    ks = jax.random.split(key, 24)
    f32 = jnp.float32
    nrm = lambda k, shape, s: jax.random.normal(k, shape, f32) * s
    return {
        'x_prompt': nrm(ks[0], (BATCH, SEQ, D_MODEL), 1.0),
        'x_sample': nrm(ks[1], (DEC_BATCH, DEC_SEQ, D_MODEL), 1.0),
        'cache_k': nrm(ks[2], (DEC_BATCH, DEPTH, PAST_LEN, N_KV_HEADS, HEAD_DIM), 1.0),
        'cache_v': nrm(ks[3], (DEC_BATCH, DEPTH, PAST_LEN, N_KV_HEADS, HEAD_DIM), 1.0),
        'c': nrm(ks[4], (DEC_BATCH, D_MODEL), 1.0),
        'c_ctx': nrm(ks[5], (D_MODEL,), 1.0),
        'norm1_g': 1.0 + nrm(ks[6], (DEPTH, D_MODEL), 0.02),
        'w_mod': nrm(ks[7], (DEPTH, D_MODEL, N_MOD * D_MODEL), 0.5 * D_MODEL ** -0.5),
        'b_mod': nrm(ks[8], (DEPTH, N_MOD * D_MODEL), 0.02),
        'w_in': nrm(ks[9], (DEPTH, D_MODEL, IN_COLS), D_MODEL ** -0.5),
        'q_norm_g': 1.0 + nrm(ks[10], (DEPTH, HEAD_DIM), 0.02),
        'k_norm_g': 1.0 + nrm(ks[11], (DEPTH, HEAD_DIM), 0.02),
        'conv_w': nrm(ks[12], (DEPTH, CONV_KERNEL, CONV_WIDTH), CONV_KERNEL ** -0.5),
        'conv_b': nrm(ks[13], (DEPTH, CONV_WIDTH), 0.02),
        'conv_norm_g': 1.0 + nrm(ks[14], (DEPTH, CONV_WIDTH), 0.02),
        'conv_norm_b': nrm(ks[15], (DEPTH, CONV_WIDTH), 0.02),
        'w_out': nrm(ks[16], (DEPTH, MIX_WIDTH, D_MODEL), MIX_WIDTH ** -0.5),
        'norm2_g': 1.0 + nrm(ks[17], (DEPTH, D_MODEL), 0.02),
        'w_ff1': nrm(ks[18], (DEPTH, D_MODEL, D_FF), D_MODEL ** -0.5),
        'w_ff2': nrm(ks[19], (DEPTH, D_FF, D_MODEL), D_FF ** -0.5),
    }


def reference(x_prompt, x_sample, cache_k, cache_v, c, c_ctx,
              norm1_g, w_mod, b_mod, w_in, q_norm_g, k_norm_g, conv_w, conv_b,
              conv_norm_g, conv_norm_b, w_out, norm2_g, w_ff1, w_ff2):
    rotary = grid_rotary(x_sample.shape[1])
    cond_ctx = c_ctx[None, :]
    y_prompt = x_prompt
    y_sample = x_sample
    ks_new, vs_new = [], []
    for l in range(DEPTH):
        p = (norm1_g[l], w_mod[l], b_mod[l], w_in[l], q_norm_g[l], k_norm_g[l], conv_w[l], conv_b[l],
             conv_norm_g[l], conv_norm_b[l], w_out[l], norm2_g[l], w_ff1[l], w_ff2[l])
        y_prompt, k_l, v_l = trunk_layer(y_prompt, cond_ctx, None, None, None, *p)
        ks_new.append(k_l)
        vs_new.append(v_l)
        y_sample, _, _ = trunk_layer(y_sample, c, rotary, cache_k[:, l], cache_v[:, l], *p)
    new_k = jnp.stack(ks_new, axis=1)
    new_v = jnp.stack(vs_new, axis=1)
    return (y_prompt, y_sample, new_k, new_v)
```

```cpp
#include <hip/hip_runtime.h>
#include <cstdio>
#include <cstdint>
#include <cmath>
namespace pg8 {
#define PG8_LAS __attribute__((address_space(3)))
typedef unsigned short bf16_t;
typedef short bf16x8 __attribute__((ext_vector_type(8)));
typedef float f32x4 __attribute__((ext_vector_type(4)));
typedef unsigned u32x4 __attribute__((ext_vector_type(4)));
constexpr int BM = 256, BK = 64, HALF = 128, HTB = HALF * BK * 2  , STAGE_BYTES = 8 * HTB, NXCD = 8, WGM = 8;

__host__ __device__ __forceinline__ int lds_byte(int r, int c) { const int st = (r >> 4) * 2 + (c >> 5), rr = r & 15, cc = c & 31, ob = rr * 64 + cc * 2; return st * 1024 + (ob ^ (((ob >> 9) & 1) << 5)); }
__host__ __device__ __forceinline__ void stage_rc(int b, int& R, int& C) { const int st = b / 1024, sb = b % 1024, swz = sb ^ (((sb >> 9) & 1) << 5); R = (st >> 1) * 16 + swz / 64; C = (st & 1) * 32 + (swz % 64) / 2; }
__host__ __device__ __forceinline__ int perm32(int rho) { const int n = rho >> 4, i = rho & 15; return 8 * (i >> 2) + 4 * n + (i & 3); }

struct Unit { int pm, pn; };
struct Gemm { const bf16_t* A; const bf16_t* Bt; int M, N, K; };

struct StaticOrder {
    int nM, nN, nwg, G, c;
    __host__ __device__ void init(int M, int N, int G_, int c_) { nM = M / BM; nN = N / BM; nwg = nM * nN; G = G_; c = c_; }
    __host__ __device__ bool next(int i, Unit& u) const {
        const long L = (long)i * G + c; if (L >= nwg) return false;
        int wgid = (int)L; { const int q = nwg / NXCD, r = nwg % NXCD, xcd = wgid % NXCD, off = wgid / NXCD; wgid = (xcd < r ? xcd * (q + 1) : r * (q + 1) + (xcd - r) * q) + off; }
        const int nig = WGM * nN, gid = wgid / nig, fm = gid * WGM, gsz = (nM - fm) < WGM ? (nM - fm) : WGM;
        u.pm = fm + ((wgid % nig) % gsz); u.pn = (wgid % nig) / gsz; return true;
    }
    __device__ __forceinline__ void a_ready(const Unit&) const {}
    __device__ __forceinline__ void done(const Unit&) const {}
};

__device__ __forceinline__ unsigned cvt_pk_bf16(float lo, float hi) { unsigned r; asm volatile("v_cvt_pk_bf16_f32 %0, %1, %2" : "=v"(r) : "v"(lo), "v"(hi)); return r; }
__device__ __forceinline__ u32x4 pack8(const f32x4 v0, const f32x4 v1) { u32x4 w; w.x = cvt_pk_bf16(v0[0], v0[1]); w.y = cvt_pk_bf16(v0[2], v0[3]); w.z = cvt_pk_bf16(v1[0], v1[1]); w.w = cvt_pk_bf16(v1[2], v1[3]); return w; }
__device__ __forceinline__ int cond_of_tile(int pm) { return pm < 16 ? 4 : ((pm - 16) >> 2); }

struct EpiProj {
    static constexpr bool PERM = true, AFTER_DRAIN = false;
    bf16_t* Q; bf16_t* KR; bf16_t* VC; bf16_t* VL; bf16_t* GLU; float* newv; int layer;
    __device__ __forceinline__ void operator()(const f32x4 (&acc)[2][2][4][2], const Unit& u, int wr, int wc, int fr, int fq) const {
        asm volatile("" : "+v"(fr), "+v"(fq));
        const int pn = u.pn, pm = u.pm;
        const int rl0 = wr * 64 + fr, cl = wc * 32 + 8 * fq;
        if (pn < 5) {
            bf16_t* base = pn < 4 ? Q + (size_t)pm * BM * 1024 + pn * 256 : KR + (size_t)pm * BM * 256;
            const int ld = pn < 4 ? 1024 : 256;
#pragma unroll
            for (int ai = 0; ai < 2; ++ai)
#pragma unroll
                for (int m = 0; m < 4; ++m) { bf16_t* rowp = base + (size_t)(rl0 + ai * HALF + m * 16) * ld + cl;
#pragma unroll
                    for (int bj = 0; bj < 2; ++bj) *(u32x4*)(rowp + bj * HALF) = pack8(acc[ai][bj][m][0], acc[ai][bj][m][1]); }
        } else if (pn == 5) {
            bf16_t* vb; float* nv = nullptr;
            if (pm < 16) { vb = VC + (size_t)pm * BM * 256; nv = newv + ((size_t)(pm * 4 + layer) * 256) * 256; }
            else { const int lb = (pm - 16) >> 2, t0 = ((pm - 16) & 3) * 256; vb = VL + ((size_t)lb * 1536 + t0) * 256; }
#pragma unroll
            for (int ai = 0; ai < 2; ++ai)
#pragma unroll
                for (int m = 0; m < 4; ++m) { const size_t ro = (size_t)(rl0 + ai * HALF + m * 16) * 256 + cl;
#pragma unroll
                    for (int bj = 0; bj < 2; ++bj) { *(u32x4*)(vb + ro + bj * HALF) = pack8(acc[ai][bj][m][0], acc[ai][bj][m][1]);
                        if (nv) { *(f32x4*)(nv + ro + bj * HALF) = acc[ai][bj][m][0]; *(f32x4*)(nv + ro + bj * HALF + 4) = acc[ai][bj][m][1]; } } }
        } else {
            bf16_t* base = GLU + (size_t)pm * BM * 1024 + (pn - 6) * 128 + cl;
#pragma unroll
            for (int ai = 0; ai < 2; ++ai)
#pragma unroll
                for (int m = 0; m < 4; ++m) { f32x4 o[2];
#pragma unroll
                    for (int n = 0; n < 2; ++n) { const f32x4 a = acc[ai][0][m][n], g = acc[ai][1][m][n];
#pragma unroll
                        for (int j = 0; j < 4; ++j) o[n][j] = a[j] * __builtin_amdgcn_rcpf(1.0f + __builtin_amdgcn_exp2f(-1.4426950408889634f * g[j])); }
                    *(u32x4*)(base + (size_t)(rl0 + ai * HALF + m * 16) * 1024) = pack8(o[0], o[1]); }
        }
    }
};
struct EpiRes {
    static constexpr bool PERM = true, AFTER_DRAIN = false;
    const float* base_c; const float* base_l; float* out; const float* gate;
    __device__ __forceinline__ void operator()(const f32x4 (&acc)[2][2][4][2], const Unit& u, int wr, int wc, int fr, int fq) const {
        asm volatile("" : "+v"(fr), "+v"(fq));
        const int pm = u.pm, col0 = u.pn * BM + wc * 32 + 8 * fq;
        const float* g = gate + (size_t)cond_of_tile(pm) * 12288 + col0;
        const float* bp = (pm < 16 ? base_c + (size_t)pm * BM * 2048 : base_l + (size_t)(pm - 16) * BM * 2048) + col0;
        float* op = out + (size_t)pm * BM * 2048 + col0;
        f32x4 gv[2][2];
#pragma unroll
        for (int bj = 0; bj < 2; ++bj)
#pragma unroll
            for (int n = 0; n < 2; ++n) gv[bj][n] = *(const f32x4*)(g + bj * HALF + 4 * n);
#pragma unroll
        for (int ai = 0; ai < 2; ++ai)
#pragma unroll
            for (int mh = 0; mh < 2; ++mh) {
                f32x4 pre[2][2][2];
#pragma unroll
                for (int m2 = 0; m2 < 2; ++m2) { const size_t ro = (size_t)(wr * 64 + fr + ai * HALF + (mh * 2 + m2) * 16) * 2048;
#pragma unroll
                    for (int bj = 0; bj < 2; ++bj)
#pragma unroll
                        for (int n = 0; n < 2; ++n) pre[m2][bj][n] = *(const f32x4*)(bp + ro + bj * HALF + 4 * n); }
                asm volatile("" ::: "memory");
#pragma unroll
                for (int m2 = 0; m2 < 2; ++m2) { const size_t ro = (size_t)(wr * 64 + fr + ai * HALF + (mh * 2 + m2) * 16) * 2048;
#pragma unroll
                    for (int bj = 0; bj < 2; ++bj)
#pragma unroll
                        for (int n = 0; n < 2; ++n) *(f32x4*)(op + ro + bj * HALF + 4 * n) = pre[m2][bj][n] + gv[bj][n] * acc[ai][bj][mh * 2 + m2][n]; }
                asm volatile("" ::: "memory");
            }
    }
};
struct EpiFF1 {
    static constexpr bool PERM = true, AFTER_DRAIN = false;
    bf16_t* H;
    __device__ __forceinline__ void operator()(const f32x4 (&acc)[2][2][4][2], const Unit& u, int wr, int wc, int fr, int fq) const {
        asm volatile("" : "+v"(fr), "+v"(fq));
        bf16_t* base = H + (size_t)(u.pm * BM + wr * 64 + fr) * 8192 + u.pn * BM + wc * 32 + 8 * fq;
#pragma unroll
        for (int ai = 0; ai < 2; ++ai)
#pragma unroll
            for (int m = 0; m < 4; ++m)
#pragma unroll
                for (int bj = 0; bj < 2; ++bj) { f32x4 v0 = acc[ai][bj][m][0], v1 = acc[ai][bj][m][1];
#pragma unroll
                    for (int j = 0; j < 4; ++j) { const float a = fmaxf(v0[j], 0.f), b = fmaxf(v1[j], 0.f); v0[j] = a * a; v1[j] = b * b; }
                    *(u32x4*)(base + (size_t)(ai * HALF + m * 16) * 8192 + bj * HALF) = pack8(v0, v1); }
    }
};

template <class Epi, class Sched, bool ALIGN_EPI = false, bool SP2 = false>
__device__ __forceinline__ void gemm_phase(PG8_LAS unsigned char* lds, const Gemm g, const Sched& S, const Epi& E) {
    int tid_ = threadIdx.x; asm volatile("" : "+v"(tid_));
    const int tid = tid_, wid = __builtin_amdgcn_readfirstlane(tid >> 6), lane = tid & 63, wr = wid >> 2, wc = wid & 3, fr = lane & 15, fq = lane >> 4;
    const int K = g.K, nt = K / BK;
    unsigned voffA[2], voffB[2];
#pragma unroll
    for (int i = 0; i < 2; ++i) { int R, C; stage_rc(tid * 16 + i * 8192, R, C); const int Rb = Epi::PERM ? ((R & ~31) + perm32(R & 31)) : R;
        voffA[i] = (unsigned)(R * K + C) * 2u; voffB[i] = (unsigned)(Rb * K + C) * 2u; }
    const size_t kstep = (size_t)(BK * 2);
    const size_t hstep = (size_t)HALF * K * 2;
    const size_t tstep = 2 * hstep;
    const unsigned ldsw = (unsigned)wid * 1024u;
    const int aoff = lds_byte(wr * 64 + fr, fq * 8), boff = lds_byte(wc * 32 + fr, fq * 8);
#define PG8_SA(b, h) (((b) * 2 + (h)) * HTB)
#define PG8_SB(b, h) ((4 + (b) * 2 + (h)) * HTB)
#define PG8_STAGE(bufoff, gbase, voff) do { _Pragma("unroll") for (int _i = 0; _i < 2; ++_i) \
        __builtin_amdgcn_global_load_lds((const unsigned*)((const char*)(gbase) + (voff)[_i]), (PG8_LAS unsigned*)(lds + (bufoff) + ldsw + _i * 8192), 16, 0, 0); } while (0)
#define PG8_LDA(dst, b, h) do { _Pragma("unroll") for (int m = 0; m < 4; ++m) _Pragma("unroll") for (int k = 0; k < 2; ++k) dst[m][k] = *(const PG8_LAS bf16x8*)(lds + PG8_SA(b, h) + aoff + m * 2048 + k * 1024); } while (0)
#define PG8_LDB(dst, b, h) do { _Pragma("unroll") for (int n = 0; n < 2; ++n) _Pragma("unroll") for (int k = 0; k < 2; ++k) dst[n][k] = *(const PG8_LAS bf16x8*)(lds + PG8_SB(b, h) + boff + n * 2048 + k * 1024); } while (0)
#define PG8_MMA(ai, bj, At, Bt) do { __builtin_amdgcn_s_setprio(1); _Pragma("unroll") for (int m = 0; m < 4; ++m) _Pragma("unroll") for (int n = 0; n < 2; ++n) _Pragma("unroll") for (int k = 0; k < 2; ++k) \
        acc[ai][bj][m][n] = __builtin_amdgcn_mfma_f32_16x16x32_bf16(Bt[n][k], At[m][k], acc[ai][bj][m][n], 0, 0, 0); __builtin_amdgcn_s_setprio(0); } while (0)
#define PG8_WAIT_V(n) asm volatile("s_waitcnt vmcnt(" #n ")" ::: "memory")
#define PG8_WAIT_L(n) asm volatile("s_waitcnt lgkmcnt(" #n ")" ::: "memory")
#define PG8_BAR __builtin_amdgcn_s_barrier()
#define PG8_SCHED __builtin_amdgcn_sched_barrier(0)
    Unit cur, nxt; int ui = 0;
    if (!S.next(0, cur)) return;
    f32x4 acc[2][2][4][2];
#pragma unroll
    for (int a = 0; a < 2; ++a)
#pragma unroll
        for (int b = 0; b < 2; ++b)
#pragma unroll
            for (int m = 0; m < 4; ++m)
#pragma unroll
                for (int n = 0; n < 2; ++n) acc[a][b][m][n] = (f32x4){0.f, 0.f, 0.f, 0.f};
    bf16x8 At[4][2], B0[2][2], B1[2][2];
    const char* cA = (const char*)g.A + (size_t)cur.pm * tstep; const char* cB = (const char*)g.Bt + (size_t)cur.pn * tstep;
    S.a_ready(cur);
    if constexpr (SP2) {
        PG8_STAGE(PG8_SB(0, 0), cB, voffB); PG8_STAGE(PG8_SB(0, 1), cB + hstep, voffB); PG8_STAGE(PG8_SA(0, 0), cA, voffA); PG8_STAGE(PG8_SA(0, 1), cA + hstep, voffA);
        if (wr == 1) PG8_BAR;
        PG8_WAIT_V(2); PG8_BAR;
        PG8_STAGE(PG8_SB(1, 0), cB + kstep, voffB); PG8_STAGE(PG8_SA(1, 0), cA + kstep, voffA); PG8_STAGE(PG8_SB(1, 1), cB + hstep + kstep, voffB);
        PG8_WAIT_V(6); PG8_BAR;
    } else {
        PG8_STAGE(PG8_SB(0, 0), cB, voffB); PG8_STAGE(PG8_SA(0, 0), cA, voffA); PG8_STAGE(PG8_SB(0, 1), cB + hstep, voffB); PG8_STAGE(PG8_SA(0, 1), cA + hstep, voffA);
        if (wr == 1) PG8_BAR;
        PG8_WAIT_V(4); PG8_BAR;
        PG8_STAGE(PG8_SB(1, 0), cB + kstep, voffB); PG8_STAGE(PG8_SA(1, 0), cA + kstep, voffA); PG8_STAGE(PG8_SB(1, 1), cB + hstep + kstep, voffB);
        PG8_WAIT_V(6); PG8_BAR;
    }
    for (;;) {
        const bool has_next = S.next(ui + 1, nxt);
        const char* nA = has_next ? (const char*)g.A + (size_t)nxt.pm * tstep : cA; const char* nB = has_next ? (const char*)g.Bt + (size_t)nxt.pn * tstep : cB;
        for (int t = 0; t < nt; t += 2) {
            const bool last = (t == nt - 2);
            const char* a1 = cA + (size_t)(t + 1) * kstep;
            const char* a2 = last ? nA : cA + (size_t)(t + 2) * kstep; const char* b2 = last ? nB : cB + (size_t)(t + 2) * kstep;
            const char* a3 = a2 + kstep; const char* b3 = b2 + kstep;
            if (last && has_next) S.a_ready(nxt);
            if constexpr (SP2) {
            PG8_LDB(B0, 0, 0); PG8_LDB(B1, 0, 1); PG8_SCHED; PG8_LDA(At, 0, 0); PG8_STAGE(PG8_SA(1, 1), a1 + hstep, voffA);
            PG8_WAIT_V(8); PG8_WAIT_L(0); PG8_BAR; PG8_MMA(0, 0, At, B0); PG8_MMA(0, 1, At, B1); PG8_BAR; PG8_SCHED;
            PG8_LDA(At, 0, 1); PG8_STAGE(PG8_SB(0, 0), b2, voffB); PG8_STAGE(PG8_SB(0, 1), b2 + hstep, voffB); PG8_STAGE(PG8_SA(0, 0), a2, voffA);
            PG8_WAIT_V(8); PG8_WAIT_L(0); PG8_BAR; PG8_MMA(1, 0, At, B0); PG8_MMA(1, 1, At, B1); PG8_BAR; PG8_SCHED;
            PG8_LDB(B0, 1, 0); PG8_LDB(B1, 1, 1); PG8_SCHED; PG8_LDA(At, 1, 0); PG8_STAGE(PG8_SA(0, 1), a2 + hstep, voffA);
            PG8_WAIT_V(8); PG8_WAIT_L(0); PG8_BAR; PG8_MMA(0, 0, At, B0); PG8_MMA(0, 1, At, B1); PG8_BAR; PG8_SCHED;
            PG8_LDA(At, 1, 1); PG8_STAGE(PG8_SB(1, 0), b3, voffB); PG8_STAGE(PG8_SB(1, 1), b3 + hstep, voffB); PG8_STAGE(PG8_SA(1, 0), a3, voffA);
            PG8_WAIT_V(8); PG8_WAIT_L(0); PG8_BAR; PG8_MMA(1, 0, At, B0); PG8_MMA(1, 1, At, B1); PG8_BAR; PG8_SCHED;
            } else {
            PG8_LDB(B0, 0, 0); PG8_SCHED; PG8_LDA(At, 0, 0); PG8_STAGE(PG8_SA(1, 1), a1 + hstep, voffA);
            PG8_WAIT_L(8); PG8_BAR; PG8_WAIT_L(0); PG8_MMA(0, 0, At, B0); PG8_BAR; PG8_SCHED;
            PG8_LDB(B1, 0, 1); PG8_STAGE(PG8_SB(0, 0), b2, voffB);
            PG8_BAR; PG8_WAIT_L(0); PG8_MMA(0, 1, At, B1); PG8_BAR;
            PG8_LDA(At, 0, 1); PG8_STAGE(PG8_SA(0, 0), a2, voffA);
            PG8_BAR; PG8_WAIT_L(0); PG8_MMA(1, 0, At, B0); PG8_BAR; PG8_SCHED;
            PG8_STAGE(PG8_SB(0, 1), b2 + hstep, voffB);
            PG8_WAIT_V(6); PG8_BAR; PG8_MMA(1, 1, At, B1); PG8_BAR;
            PG8_LDB(B0, 1, 0); PG8_SCHED; PG8_LDA(At, 1, 0); PG8_STAGE(PG8_SA(0, 1), a2 + hstep, voffA);
            PG8_WAIT_L(8); PG8_BAR; PG8_WAIT_L(0); PG8_MMA(0, 0, At, B0); PG8_BAR; PG8_SCHED;
            PG8_LDB(B1, 1, 1); PG8_STAGE(PG8_SB(1, 0), b3, voffB);
            PG8_BAR; PG8_WAIT_L(0); PG8_MMA(0, 1, At, B1); PG8_BAR;
            PG8_LDA(At, 1, 1); PG8_STAGE(PG8_SA(1, 0), a3, voffA);
            PG8_BAR; PG8_WAIT_L(0); PG8_MMA(1, 0, At, B0); PG8_BAR; PG8_SCHED;
            PG8_STAGE(PG8_SB(1, 1), b3 + hstep, voffB);
            PG8_WAIT_V(6); PG8_BAR; PG8_MMA(1, 1, At, B1); PG8_BAR;
            }
        }
        if constexpr (ALIGN_EPI) { if (wr == 0) PG8_BAR; }
        if constexpr (!Epi::AFTER_DRAIN) { E(acc, cur, wr, wc, fr, fq); S.done(cur); }
        if (!has_next) break;
#pragma unroll
        for (int a = 0; a < 2; ++a)
#pragma unroll
            for (int b = 0; b < 2; ++b)
#pragma unroll
                for (int m = 0; m < 4; ++m)
#pragma unroll
                    for (int n = 0; n < 2; ++n) acc[a][b][m][n] = (f32x4){0.f, 0.f, 0.f, 0.f};
        cur = nxt; cA = nA; cB = nB; ++ui;
        if constexpr (ALIGN_EPI) { if (wr == 1) PG8_BAR; }
    }
    PG8_WAIT_V(0);
    if constexpr (!ALIGN_EPI) { if (wr == 0) PG8_BAR; }
    PG8_BAR;
    if constexpr (Epi::AFTER_DRAIN) { E.fused(acc, cur, wr, wc, fr, fq, lds, wid, lane); S.done(cur); }
#undef PG8_SA
#undef PG8_SB
#undef PG8_STAGE
#undef PG8_LDA
#undef PG8_LDB
#undef PG8_MMA
#undef PG8_WAIT_V
#undef PG8_WAIT_L
#undef PG8_BAR
#undef PG8_SCHED
}
}
namespace att {
typedef unsigned short bf16;
constexpr int   D = 128, NW = 8, QBLK = 32, KVBLK = 64;
constexpr float SCALE = 0.088388347648318440f;
constexpr float THR = 8.f;
constexpr int SDEPTH = 2;
constexpr int LDQ = 1024, LDK = 256, LDO = 2048;
constexpr size_t SHM_V = KVBLK * D * 2, SHM_K = KVBLK * D * 2, SHM_ATTN = 2 * SHM_V + 2 * SHM_K + NW * 64 * 4;
using bf16x8 = __attribute__((ext_vector_type(8))) short;
using s16x4  = __attribute__((ext_vector_type(4))) short;
using f32x16 = __attribute__((ext_vector_type(16))) float;
using u32x4  = __attribute__((ext_vector_type(4))) unsigned;
using f32x4  = __attribute__((ext_vector_type(4))) float;
#define KSWZ(row, colB) ((row) * 256 + ((colB) ^ (((row) & 7) << 4)))
#define SBAR() __builtin_amdgcn_sched_barrier(0)
__device__ __forceinline__ int crow(int r, int hi) { return (r & 3) + 8 * (r >> 2) + 4 * hi; }
__device__ __forceinline__ unsigned cvtpk(float lo, float hi) { unsigned r; asm volatile("v_cvt_pk_bf16_f32 %0, %1, %2" : "=v"(r) : "v"(lo), "v"(hi)); return r; }

__device__ __forceinline__ void partialSM(f32x16& p0, f32x16& p1, float& m_reg, float& mn, float& alpha) {
  constexpr float C = SCALE * 1.4426950408889634f;
  float pmax = p0[0]; for (int r = 1; r < 16; ++r) pmax = fmaxf(pmax, p0[r]); for (int r = 0; r < 16; ++r) pmax = fmaxf(pmax, p1[r]);
  { auto rr = __builtin_amdgcn_permlane32_swap(__float_as_uint(pmax), __float_as_uint(pmax), false, false);
    pmax = fmaxf(__uint_as_float(rr[0]), __uint_as_float(rr[1])); }
  if (__builtin_expect(__all(pmax - m_reg <= THR / SCALE), 1)) { mn = m_reg; alpha = 1.f; }
  else { mn = fmaxf(m_reg, pmax); alpha = __builtin_amdgcn_exp2f((m_reg - mn) * C); m_reg = mn; }
  float mnC = -mn * C;
  for (int r = 0; r < 16; ++r) p0[r] = fmaf(p0[r], C, mnC); for (int r = 0; r < 16; ++r) p1[r] = fmaf(p1[r], C, mnC);
  for (int r = 0; r < 16; ++r) p0[r] = __builtin_amdgcn_exp2f(p0[r]);
}
__device__ __forceinline__ void finishSM(f32x16& p0, f32x16& p1, float alpha, float& l_reg, bf16x8& pa0, bf16x8& pa1, bf16x8& pa2, bf16x8& pa3) {
  for (int r = 0; r < 16; ++r) p1[r] = __builtin_amdgcn_exp2f(p1[r]);
  float ps = 0; for (int r = 0; r < 16; ++r) ps += p0[r]; for (int r = 0; r < 16; ++r) ps += p1[r];
  { auto rr = __builtin_amdgcn_permlane32_swap(__float_as_uint(ps), __float_as_uint(ps), false, false);
    ps = __uint_as_float(rr[0]) + __uint_as_float(rr[1]); }
  l_reg = l_reg * alpha + ps;
#define PK4(P, BASE, OUT) do { unsigned a0 = cvtpk(P[BASE + 0], P[BASE + 1]), a1 = cvtpk(P[BASE + 2], P[BASE + 3]);   \
    unsigned b0 = cvtpk(P[BASE + 4], P[BASE + 5]), b1 = cvtpk(P[BASE + 6], P[BASE + 7]);                              \
    auto r0 = __builtin_amdgcn_permlane32_swap(a0, b0, false, false); auto r1 = __builtin_amdgcn_permlane32_swap(a1, b1, false, false); \
    u32x4 w = {r0[0], r1[0], r0[1], r1[1]}; OUT = *reinterpret_cast<bf16x8*>(&w); } while (0)
  PK4(p0, 0, pa0); PK4(p0, 8, pa1); PK4(p1, 0, pa2); PK4(p1, 8, pa3);
#undef PK4
}
__device__ __forceinline__ void qkt(f32x16& p0, f32x16& p1, const bf16* Ks, const bf16x8* qr, int r32, int hi) {
  p0 = f32x16{}; p1 = f32x16{};
  for (int d0 = 0; d0 < 8; ++d0) { int cb = (d0 * 16 + hi * 8) * 2;
    bf16x8 b0 = *reinterpret_cast<const bf16x8*>((const char*)Ks + KSWZ(r32, cb));
    bf16x8 b1 = *reinterpret_cast<const bf16x8*>((const char*)Ks + KSWZ(32 + r32, cb));
    p0 = __builtin_amdgcn_mfma_f32_32x32x16_bf16(b0, qr[d0], p0, 0, 0, 0);
    p1 = __builtin_amdgcn_mfma_f32_32x32x16_bf16(b1, qr[d0], p1, 0, 0, 0); }
}
__device__ __forceinline__ int v_st(int k, int c) { const int kk = (k & ~0xC) | ((k & 4) << 1) | ((k & 8) >> 1); return ((kk >> 3) * 4 + (c >> 5)) * 512 + ((kk & 7) * 32 + (c & 31)) * 2; }
__device__ __forceinline__ int v_rd_base(int lane) { return ((lane & 3) << 3) | (((lane >> 2) & 3) << 6) | (((lane >> 4) & 1) << 5) | (((lane >> 5) & 1) << 8); }
constexpr int v_rd_off(int d0, int ks, int half) { return d0 * 512 + ks * 4096 + half * 2048; }
template <int OFF> __device__ __forceinline__ s16x4 tr_read(int vb) {
  s16x4 r; asm volatile("ds_read_b64_tr_b16 %0, %1 offset:%2" : "=&v"(r) : "v"(vb), "i"(OFF) : "memory"); return r;
}
template <int D0> __device__ __forceinline__ void pv_one(f32x16& od, int vb, bf16x8 pa0, bf16x8 pa1, bf16x8 pa2, bf16x8 pa3) {
  const s16x4 l0 = tr_read<v_rd_off(D0, 0, 0)>(vb), h0 = tr_read<v_rd_off(D0, 0, 1)>(vb), l1 = tr_read<v_rd_off(D0, 1, 0)>(vb), h1 = tr_read<v_rd_off(D0, 1, 1)>(vb);
  const s16x4 l2 = tr_read<v_rd_off(D0, 2, 0)>(vb), h2 = tr_read<v_rd_off(D0, 2, 1)>(vb), l3 = tr_read<v_rd_off(D0, 3, 0)>(vb), h3 = tr_read<v_rd_off(D0, 3, 1)>(vb);
  asm volatile("s_waitcnt lgkmcnt(0)" ::: "memory"); SBAR();
#define PK(L, H) (bf16x8){L[0], L[1], L[2], L[3], H[0], H[1], H[2], H[3]}
  od = __builtin_amdgcn_mfma_f32_32x32x16_bf16(pa0, PK(l0, h0), od, 0, 0, 0);
  od = __builtin_amdgcn_mfma_f32_32x32x16_bf16(pa1, PK(l1, h1), od, 0, 0, 0);
  od = __builtin_amdgcn_mfma_f32_32x32x16_bf16(pa2, PK(l2, h2), od, 0, 0, 0);
  od = __builtin_amdgcn_mfma_f32_32x32x16_bf16(pa3, PK(l3, h3), od, 0, 0, 0);
#undef PK
}
__device__ __forceinline__ void pv_d0(f32x16* o, int vb, bf16x8 pa0, bf16x8 pa1, bf16x8 pa2, bf16x8 pa3) {
  pv_one<0>(o[0], vb, pa0, pa1, pa2, pa3); pv_one<1>(o[1], vb, pa0, pa1, pa2, pa3); pv_one<2>(o[2], vb, pa0, pa1, pa2, pa3); pv_one<3>(o[3], vb, pa0, pa1, pa2, pa3);
}
__device__ __forceinline__ float bf2f(short s) { return __uint_as_float(((unsigned)(unsigned short)s) << 16); }

constexpr int ROT_SIN_OFF = 1024 * 64;
__device__ __forceinline__ void attn_unit(const bf16* Qb, const float* __restrict__ gq, const float* __restrict__ rot, const bf16* __restrict__ Kh, const bf16* __restrict__ Vh,
                                          bf16* Ob, int seq, char* lds) {
  int tid_ = threadIdx.x; asm volatile("" : "+v"(tid_));
  const int tid = tid_, wid = tid >> 6, lane = tid & 63, r32 = lane & 31, hi = lane >> 5;
  bf16* V_lds = (bf16*)lds; bf16* K_lds = (bf16*)(lds + 2 * SHM_V);
  float* ws = (float*)(lds + 2 * SHM_V + 2 * SHM_K) + wid * 64; float* li_l = ws; float* al_l = ws + 32;
  float m_reg = -1e30f, l_reg = 0; f32x16 o[4] = {}; bf16x8 qr[8];
  {
    const bf16* Qw = Qb + (long)(wid * QBLK + r32) * LDQ + hi * 8;
    bf16x8 raw[8]; float ss = 0.f;
#pragma unroll
    for (int d0 = 0; d0 < 8; ++d0) raw[d0] = *reinterpret_cast<const bf16x8*>(Qw + d0 * 16);
#pragma unroll
    for (int d0 = 0; d0 < 8; ++d0)
#pragma unroll
      for (int e = 0; e < 8; ++e) { const float x = bf2f(raw[d0][e]); ss += x * x; }
    { auto rr = __builtin_amdgcn_permlane32_swap(__float_as_uint(ss), __float_as_uint(ss), false, false); ss = __uint_as_float(rr[0]) + __uint_as_float(rr[1]); }
    const float rstd = 1.0f / sqrtf(ss * (1.0f / 128.0f) + 1e-6f);
    const float* cr = rot ? rot + (long)(wid * QBLK + r32) * 64 + hi * 8 : nullptr;
#pragma unroll
    for (int d0 = 0; d0 < 4; ++d0) {
      float x1[8], x2[8];
      const f32x4 ga0 = *(const f32x4*)(gq + d0 * 16 + hi * 8), ga1 = *(const f32x4*)(gq + d0 * 16 + hi * 8 + 4);
      const f32x4 gb0 = *(const f32x4*)(gq + 64 + d0 * 16 + hi * 8), gb1 = *(const f32x4*)(gq + 64 + d0 * 16 + hi * 8 + 4);
#pragma unroll
      for (int e = 0; e < 8; ++e) { x1[e] = bf2f(raw[d0][e]) * rstd * (e < 4 ? ga0[e & 3] : ga1[e & 3]); x2[e] = bf2f(raw[d0 + 4][e]) * rstd * (e < 4 ? gb0[e & 3] : gb1[e & 3]); }
      if (rot) {
        const f32x4 c0 = *(const f32x4*)(cr + d0 * 16), c1 = *(const f32x4*)(cr + d0 * 16 + 4);
        const f32x4 s0 = *(const f32x4*)(cr + ROT_SIN_OFF + d0 * 16), s1 = *(const f32x4*)(cr + ROT_SIN_OFF + d0 * 16 + 4);
#pragma unroll
        for (int e = 0; e < 8; ++e) { const float c = e < 4 ? c0[e & 3] : c1[e & 3], s = e < 4 ? s0[e & 3] : s1[e & 3]; const float a = x1[e], b = x2[e]; x1[e] = a * c - b * s; x2[e] = b * c + a * s; }
      }
      u32x4 w1 = {cvtpk(x1[0], x1[1]), cvtpk(x1[2], x1[3]), cvtpk(x1[4], x1[5]), cvtpk(x1[6], x1[7])};
      u32x4 w2 = {cvtpk(x2[0], x2[1]), cvtpk(x2[2], x2[3]), cvtpk(x2[4], x2[5]), cvtpk(x2[6], x2[7])};
      qr[d0] = *reinterpret_cast<bf16x8*>(&w1); qr[d0 + 4] = *reinterpret_cast<bf16x8*>(&w2);
    }
  }
  const int sr = tid >> 4, sc = (tid & 15) * 8, vst0 = v_st(sr, sc), vst1 = v_st(32 + sr, sc);
  const int vb0 = (int)(uintptr_t)V_lds + v_rd_base(lane);
  struct { bf16x8 vs0, vs1, ks0, ks1; } sr_[SDEPTH];
#define SLOAD(i, k0) do { sr_[i].vs0 = *reinterpret_cast<const bf16x8*>(&Vh[(long)((k0) + sr) * LDK + sc]); sr_[i].vs1 = *reinterpret_cast<const bf16x8*>(&Vh[(long)((k0) + 32 + sr) * LDK + sc]); \
    sr_[i].ks0 = *reinterpret_cast<const bf16x8*>(&Kh[(long)((k0) + sr) * LDK + sc]); sr_[i].ks1 = *reinterpret_cast<const bf16x8*>(&Kh[(long)((k0) + 32 + sr) * LDK + sc]); } while (0)
#define SWRITE(b, i) do { *(bf16x8*)((char*)V_lds + (b) * SHM_V + vst0) = sr_[i].vs0;          \
    *(bf16x8*)((char*)V_lds + (b) * SHM_V + vst1) = sr_[i].vs1; int kc = sc * 2;               \
    *(bf16x8*)((char*)K_lds + (b) * SHM_K + KSWZ(sr, kc)) = sr_[i].ks0;                       \
    *(bf16x8*)((char*)K_lds + (b) * SHM_K + KSWZ(32 + sr, kc)) = sr_[i].ks1; } while (0)
#define SWAIT() asm volatile("s_waitcnt vmcnt(4)" ::: "memory")
#define RESC(a) do { if (__any((a) < 1.f)) { if (hi == 0) al_l[r32] = (a); asm volatile("s_waitcnt lgkmcnt(0)" ::: "memory"); \
    for (int d = 0; d < 4; ++d) for (int r = 0; r < 16; ++r) o[d][r] *= al_l[crow(r, hi)]; } } while (0)
  f32x16 pA0, pA1, pB0, pB1; float mnA, mnB, alA, alB; bf16x8 pa0, pa1, pa2, pa3; const int NT = seq / KVBLK;
  constexpr int SE = 0, SO = SDEPTH - 1;
  SLOAD(SE, 0); asm volatile("s_waitcnt vmcnt(0)" ::: "memory"); SWRITE(0, SE); __syncthreads();
  qkt(pA0, pA1, K_lds, qr, r32, hi); partialSM(pA0, pA1, m_reg, mnA, alA);
  SLOAD(SO, KVBLK); if (2 < NT) SLOAD(SE, 2 * KVBLK);
  SWAIT(); SWRITE(1, SO); __syncthreads();
  for (int j = 1; j + 1 < NT; j += 2) {
    SBAR(); qkt(pB0, pB1, (bf16*)((char*)K_lds + SHM_K), qr, r32, hi);
    finishSM(pA0, pA1, alA, l_reg, pa0, pa1, pa2, pa3); SBAR();
    SLOAD(SO, (j + SDEPTH) * KVBLK); SBAR();
    pv_d0(o, vb0, pa0, pa1, pa2, pa3); partialSM(pB0, pB1, m_reg, mnB, alB);
    __syncthreads(); SWAIT(); SWRITE(0, SE);
    RESC(alB); __syncthreads();
    SBAR(); qkt(pA0, pA1, K_lds, qr, r32, hi);
    finishSM(pB0, pB1, alB, l_reg, pa0, pa1, pa2, pa3); SBAR();
    if (j + 3 < NT) SLOAD(SE, (j + 1 + SDEPTH) * KVBLK); SBAR();
    pv_d0(o, vb0 + (int)SHM_V, pa0, pa1, pa2, pa3); partialSM(pA0, pA1, m_reg, mnA, alA);
    __syncthreads(); SWAIT(); SWRITE(1, SO);
    RESC(alA); __syncthreads();
  }
  SBAR(); qkt(pB0, pB1, (bf16*)((char*)K_lds + SHM_K), qr, r32, hi);
  finishSM(pA0, pA1, alA, l_reg, pa0, pa1, pa2, pa3); SBAR();
  pv_d0(o, vb0, pa0, pa1, pa2, pa3); partialSM(pB0, pB1, m_reg, mnB, alB);
  __syncthreads(); RESC(alB);
  finishSM(pB0, pB1, alB, l_reg, pa0, pa1, pa2, pa3); SBAR();
  pv_d0(o, vb0 + (int)SHM_V, pa0, pa1, pa2, pa3);
  if (hi == 0) li_l[r32] = l_reg; asm volatile("s_waitcnt lgkmcnt(0)" ::: "memory");
  float rli[16];
#pragma unroll
  for (int r = 0; r < 16; ++r) rli[r] = __builtin_amdgcn_rcpf(li_l[crow(r, hi)]);
  bf16* Ow = Ob + (long)(wid * QBLK) * LDO;
#pragma unroll
  for (int r = 0; r < 16; ++r) { int orow = crow(r, hi);
#pragma unroll
    for (int d0 = 0; d0 < 4; ++d0) Ow[(long)orow * LDO + d0 * 32 + r32] = (bf16)(cvtpk(o[d0][r] * rli[r], 0.f) & 0xffffu); }
  __syncthreads();
#undef SLOAD
#undef SWRITE
#undef SWAIT
#undef RESC
}
#undef KSWZ
#undef SBAR
}

#define GAS __attribute__((address_space(1)))
#define LAS __attribute__((address_space(3)))
typedef unsigned short bf16;
typedef unsigned v4u __attribute__((ext_vector_type(4)));
typedef float f32x4 __attribute__((ext_vector_type(4)));
typedef short bf16x8 __attribute__((ext_vector_type(8)));
typedef GAS unsigned gu32;
typedef GAS unsigned long long gu64;
#define RLX_AGENT __ATOMIC_RELAXED, __HIP_MEMORY_SCOPE_AGENT
#define LDS_WAIT() asm volatile("s_waitcnt lgkmcnt(0)" ::: "memory")
#define VM_WAIT() asm volatile("s_waitcnt vmcnt(0)" ::: "memory")
__device__ __forceinline__ unsigned long long rt() { return __builtin_amdgcn_s_memrealtime(); }
__device__ __forceinline__ unsigned f2bf(float f) { unsigned u = __builtin_bit_cast(unsigned, f); return (u + 0x7fffu + ((u >> 16) & 1u)) >> 16; }
__device__ __forceinline__ unsigned pk2(float lo, float hi) { return f2bf(lo) | (f2bf(hi) << 16); }

#define XB_TMO      128
#define XB_XCNT(j)  (256  + 64 * (j))
#define XB_XSUB(j)  (1280 + 64 * (j))
#define XB_XGEN(j)  (2304 + 64 * (j))
#define XB_TOP      3328
#define XB_TOPGEN   3392
#define XCD_BAR_WORDS 3456
#define XB_SPIN_CAP (1u << 18)

__device__ __forceinline__ unsigned xb_ld(unsigned* p)              { return __hip_atomic_load(p, __ATOMIC_RELAXED, __HIP_MEMORY_SCOPE_AGENT); }
__device__ __forceinline__ unsigned xb_add(unsigned* p, unsigned v) { return __hip_atomic_fetch_add(p, v, __ATOMIC_RELAXED, __HIP_MEMORY_SCOPE_AGENT); }
__device__ __forceinline__ unsigned xb_xcc_id() { return (unsigned)__builtin_amdgcn_s_getreg((3 << 11) | 20) & 0xFu; }
#define XB_SPIN(cond, bar) do { unsigned _sp = 0; while (cond) { __builtin_amdgcn_s_sleep(1); \
    if ((++_sp & 255u) == 0u) { if (xb_ld(&(bar)[XB_TMO])) break; if (_sp > XB_SPIN_CAP) { atomicAdd(&(bar)[XB_TMO], 1u); break; } } } } while (0)

struct XcdBarrier {
    unsigned* bar; unsigned x;
    volatile LAS unsigned* st;
};

__device__ __forceinline__ XcdBarrier xcd_barrier_post(unsigned* bar, volatile LAS unsigned* st) {
    XcdBarrier b; b.bar = bar; b.x = xb_xcc_id(); b.st = st;
    if (threadIdx.x == 0) (void)xb_add(&bar[XB_XCNT(b.x)], 1u);
    return b;
}
__device__ __forceinline__ void xcd_barrier_complete(unsigned* bar, unsigned x, unsigned& nloc, unsigned& nx) {
    const unsigned G = gridDim.x * gridDim.y * gridDim.z;
    unsigned sum, cnt, mine, sp = 0u;
    for (;;) {
        sum = 0u; cnt = 0u; mine = 0u;
#pragma unroll
        for (unsigned j = 0; j < 16; ++j) { const unsigned c = xb_ld(&bar[XB_XCNT(j)]); sum += c; cnt += (c > 0u) ? 1u : 0u; mine = (j == x) ? c : mine; }
        if (sum == G) break;
        __builtin_amdgcn_s_sleep(1);
        if ((++sp & 255u) == 0u) { if (xb_ld(&bar[XB_TMO])) break; if (sp > XB_SPIN_CAP) { atomicAdd(&bar[XB_TMO], 1u); break; } }
    }
    nloc = mine > 0u ? mine : 1u; nx = cnt > 0u ? cnt : 1u;
}

__device__ __forceinline__ void xcd_barrier(const XcdBarrier& b) {
    asm volatile("s_waitcnt vmcnt(0)" ::: "memory");
    __syncthreads();
    if (threadIdx.x == 0) {
        unsigned* bar = b.bar;
        __builtin_amdgcn_s_waitcnt(0);
        unsigned nloc = b.st[0], nx = b.st[1];
        if (nloc == 0u) { xcd_barrier_complete(bar, b.x, nloc, nx); b.st[0] = nloc; b.st[1] = nx; }
        const unsigned old = xb_add(&bar[XB_XSUB(b.x)], 1u);
        const unsigned gen = old / nloc;
        if (old + 1u == (gen + 1u) * nloc) {
            __builtin_amdgcn_fence(__ATOMIC_RELEASE, "agent");
            asm volatile("s_waitcnt vmcnt(0)" ::: "memory");
            const unsigned og = xb_add(&bar[XB_TOP], 1u);
            const unsigned tg = og / nx;
            if (og + 1u == (tg + 1u) * nx) xb_add(&bar[XB_TOPGEN], 1u);
            else XB_SPIN(xb_ld(&bar[XB_TOPGEN]) == tg, bar);
            __builtin_amdgcn_fence(__ATOMIC_ACQUIRE, "agent");
            xb_add(&bar[XB_XGEN(b.x)], 1u);
            asm volatile("s_waitcnt vmcnt(0)" ::: "memory");
        } else {
            XB_SPIN(xb_ld(&bar[XB_XGEN(b.x)]) == gen, bar);
            __builtin_amdgcn_fence(__ATOMIC_ACQUIRE, "agent");
            asm volatile("s_waitcnt vmcnt(0)" ::: "memory");
        }
    }
    __syncthreads();
}

constexpr int NWAVES = 8;
constexpr int DM = 2048, M = 8192, NCTX = 4096, DEPTH = 4, INC = 3584, DFF = 8192, NMODC = 12288;
constexpr int SEQ_C = 256, SEQ_L = 1024, PAST = 512, KVL = 1536;
constexpr float EPS = 1e-6f;

constexpr size_t MiB = 1u << 20;
constexpr size_t WS_CTL = 0, CTL_ZERO_BYTES = 1 * MiB;
constexpr size_t WS_MOD = 1 * MiB;
constexpr size_t WS_ROT = 2 * MiB;
constexpr size_t WS_WIN = 4 * MiB;
constexpr size_t WS_WOUT = WS_WIN + (size_t)DEPTH * INC * DM * 2;
constexpr size_t WS_W1 = WS_WOUT + (size_t)DEPTH * DM * DM * 2;
constexpr size_t WS_W2 = WS_W1 + (size_t)DEPTH * DFF * DM * 2;
constexpr size_t WS_XN = WS_W2 + (size_t)DEPTH * DFF * DM * 2;
constexpr size_t WS_Q = WS_XN + (size_t)M * DM * 2;
constexpr size_t WS_KR = WS_Q + (size_t)M * 1024 * 2;
constexpr size_t WS_KC = WS_KR + (size_t)M * 256 * 2;
constexpr size_t WS_VC = WS_KC + (size_t)NCTX * 256 * 2;
constexpr size_t WS_KL = WS_VC + (size_t)NCTX * 256 * 2;
constexpr size_t WS_VL = WS_KL + (size_t)DEPTH * 4 * KVL * 256 * 2;
constexpr size_t WS_GLU = WS_VL + (size_t)DEPTH * 4 * KVL * 256 * 2;
constexpr size_t WS_MIX = WS_GLU + (size_t)M * 1024 * 2;
constexpr size_t WS_H = WS_MIX + (size_t)M * DM * 2;
constexpr size_t WS_END = WS_H + (size_t)M * DFF * 2;
constexpr int CW_BAR = 4096;
constexpr int CW_CVT = 64;

constexpr int RING_OFF = 0, RING_BYTES = 131072;
constexpr int LDSCTL_OFF = RING_BYTES, MISC_OFF = LDSCTL_OFF + 320;
constexpr int LDS_BYTES = 147456;

__device__ __forceinline__ float wave_sum(float v) {
#pragma unroll
    for (int o = 1; o < 64; o <<= 1) v += __shfl_xor(v, o);
    return v;
}
__device__ __forceinline__ float bfu2f(unsigned short s) { return __uint_as_float(((unsigned)s) << 16); }
__device__ __forceinline__ unsigned cvtpk2(float lo, float hi) { unsigned r; asm volatile("v_cvt_pk_bf16_f32 %0, %1, %2" : "=v"(r) : "v"(lo), "v"(hi)); return r; }

struct Frame {
    LAS unsigned char* lds;
    int tid, lane, wave, vcu, G;
};

__device__ __forceinline__ void transpose_item(const float* W, int K, int N, bf16* WT, int k0, int n0, int drow0, LAS float* scr, int lane) {
#pragma unroll 8
    for (int i = 0; i < 32; ++i) { const int kk = 2 * i + (lane >> 5); scr[kk * 33 + (lane & 31)] = W[(size_t)(k0 + kk) * N + n0 + (lane & 31)]; }
    LDS_WAIT(); asm volatile("" ::: "memory");
    const int c = lane & 7;
#pragma unroll
    for (int j = 0; j < 4; ++j) { const int n = (lane >> 3) + 8 * j; const LAS float* s = scr + (8 * c) * 33 + n;
        v4u o; o.x = pk2(s[0 * 33], s[1 * 33]); o.y = pk2(s[2 * 33], s[3 * 33]); o.z = pk2(s[4 * 33], s[5 * 33]); o.w = pk2(s[6 * 33], s[7 * 33]);
        *(GAS v4u*)(WT + (size_t)(drow0 + n) * K + k0 + 8 * c) = o; }
    LDS_WAIT(); asm volatile("" ::: "memory");
}
__device__ __forceinline__ int win_dest_row(int n) {
    if (n < 1536) return n;
    const int u = n - 1536;
    if (u < 1024) return 1536 + (u >> 7) * 256 + (u & 127);
    const int g = u - 1024; return 1536 + (g >> 7) * 256 + 128 + (g & 127);
}


typedef float f32x2g __attribute__((ext_vector_type(2)));
__device__ __forceinline__ void norm_rows(int gw, int NGW, int lane_in, const float* xc, const float* xl, const float* g, const float* modl, int shift_chunk, int scale_chunk, bf16* XN) {
    int lane = lane_in; asm volatile("" : "+v"(lane));
    for (int row = gw; row < M; row += NGW) {
        const float* xr = row < NCTX ? xc + (size_t)row * DM : xl + (size_t)(row - NCTX) * DM;
        const int ci = row < NCTX ? 4 : ((row - NCTX) >> 10);
        const float* sh = modl + (size_t)ci * NMODC + shift_chunk * 2048; const float* sc = modl + (size_t)ci * NMODC + scale_chunk * 2048;
        f32x4 v[8]; float s = 0.f;
#pragma unroll
        for (int j = 0; j < 8; ++j) { v[j] = *(const GAS f32x4*)(xr + (lane + 64 * j) * 4); s += (v[j][0] * v[j][0] + v[j][1] * v[j][1]) + (v[j][2] * v[j][2] + v[j][3] * v[j][3]); }
        const float rstd = 1.0f / sqrtf(wave_sum(s) * (1.0f / DM) + EPS);
#pragma unroll
        for (int j = 0; j < 8; ++j) { const int c = (lane + 64 * j) * 4;
            const f32x4 gg = *(const GAS f32x4*)(g + c), sv = *(const GAS f32x4*)(sc + c), hv = *(const GAS f32x4*)(sh + c);
            const f32x4 o = v[j] * rstd * gg * (sv + 1.0f) + hv;
            *(GAS unsigned long long*)(XN + (size_t)row * DM + c) = (unsigned long long)cvtpk2(o[0], o[1]) | ((unsigned long long)cvtpk2(o[2], o[3]) << 32); }
    }
}
__device__ __forceinline__ void knorm_rows(int gw, int NGW, int lane_in, const bf16* KR, const float* gk, const float* ROT, float* new_k, int l, bf16* KC, bf16* KLl) {
    int lane = lane_in; asm volatile("" : "+v"(lane));
    const float g1 = gk[lane], g2 = gk[64 + lane];
    for (int row = gw; row < M; row += NGW) {
#pragma unroll
        for (int hh = 0; hh < 2; ++hh) {
            const bf16* kp = KR + (size_t)row * 256 + hh * 128 + lane;
            float k1 = bfu2f(kp[0]), k2 = bfu2f(kp[64]);
            const float rstd = 1.0f / sqrtf(wave_sum(k1 * k1 + k2 * k2) * (1.0f / 128.0f) + EPS);
            k1 *= rstd * g1; k2 *= rstd * g2;
            if (row < NCTX) {
                const int b = row >> 8, t = row & 255;
                float* nk = new_k + ((size_t)(b * DEPTH + l) * 256 + t) * 256 + hh * 128 + lane; nk[0] = k1; nk[64] = k2;
                bf16* kc = KC + (size_t)row * 256 + hh * 128 + lane; kc[0] = (bf16)(cvtpk2(k1, 0.f) & 0xffffu); kc[64] = (bf16)(cvtpk2(k2, 0.f) & 0xffffu);
            } else {
                const int r = row - NCTX, b = r >> 10, p = r & 1023;
                const float c = ROT[p * 64 + lane], s = ROT[65536 + p * 64 + lane];
                const float y1 = k1 * c - k2 * s, y2 = k2 * c + k1 * s;
                bf16* kl = KLl + ((size_t)b * KVL + p) * 256 + hh * 128 + lane; kl[0] = (bf16)(cvtpk2(y1, 0.f) & 0xffffu); kl[64] = (bf16)(cvtpk2(y2, 0.f) & 0xffffu);
            }
        }
    }
}
constexpr int CONV_TILE_BYTES = 62 * 2048, CONV_RED_OFF = CONV_TILE_BYTES, CONV_STAT_OFF = CONV_RED_OFF + 2048;
static_assert(CONV_STAT_OFF + 256 <= RING_BYTES, "conv LDS");
__device__ __forceinline__ void conv_unit(int cu, LAS unsigned char* lds, int tid_in, const bf16* GLU, const float* cw, const float* cb, const float* cng, const float* cnb, bf16* MIX) {
    int tid = tid_in; asm volatile("" : "+v"(tid));
    const int lane = tid & 63, wave = tid >> 6;
    const int row0 = cu * 32;
    const int seq0 = row0 < NCTX ? (row0 & ~255) : NCTX + ((row0 - NCTX) & ~1023), seq1 = seq0 + (row0 < NCTX ? 256 : 1024);
#pragma unroll 4
    for (int i = 0; i < 16; ++i) { const int r = i * 4 + (tid >> 7);
        if (r < 62) { const int grow = row0 - 15 + r; v4u val = (v4u){0u, 0u, 0u, 0u};
            if (grow >= seq0 && grow < seq1) val = *(const GAS v4u*)(GLU + (size_t)grow * 1024 + (tid & 127) * 8);
            *(LAS v4u*)(lds + r * 2048 + (tid & 127) * 16) = val; } }
    float w0[31], w1[31];
#pragma unroll
    for (int j = 0; j < 31; ++j) { const f32x2g w = *(const GAS f32x2g*)(cw + j * 1024 + 2 * tid); w0[j] = w.x; w1[j] = w.y; }
    const f32x2g bia = *(const GAS f32x2g*)(cb + 2 * tid), lg = *(const GAS f32x2g*)(cng + 2 * tid), lb = *(const GAS f32x2g*)(cnb + 2 * tid);
    __syncthreads();
    float a0[32], a1[32];
#pragma unroll
    for (int p = 0; p < 32; ++p) { a0[p] = bia.x; a1[p] = bia.y; }
#pragma unroll
    for (int r = 0; r < 62; ++r) { const unsigned pk = *(const LAS unsigned*)(lds + r * 2048 + tid * 4);
        const float v0 = __uint_as_float(pk << 16), v1 = __uint_as_float(pk & 0xffff0000u);
#pragma unroll
        for (int p = (r > 30 ? r - 30 : 0); p <= (r < 31 ? r : 31); ++p) { a0[p] += w0[r - p] * v0; a1[p] += w1[r - p] * v1; } }
    float st[64];
#pragma unroll
    for (int p = 0; p < 32; ++p) { st[p] = a0[p] + a1[p]; st[32 + p] = a0[p] * a0[p] + a1[p] * a1[p]; }
#pragma unroll
    for (int i = 0; i < 32; ++i) { const bool up = (lane & 32) != 0; const float mine = up ? st[i + 32] : st[i], oth = up ? st[i] : st[i + 32]; st[i] = mine + __shfl_xor(oth, 32); }
#pragma unroll
    for (int i = 0; i < 16; ++i) { const bool up = (lane & 16) != 0; const float mine = up ? st[i + 16] : st[i], oth = up ? st[i] : st[i + 16]; st[i] = mine + __shfl_xor(oth, 16); }
#pragma unroll
    for (int i = 0; i < 8; ++i) { const bool up = (lane & 8) != 0; const float mine = up ? st[i + 8] : st[i], oth = up ? st[i] : st[i + 8]; st[i] = mine + __shfl_xor(oth, 8); }
#pragma unroll
    for (int i = 0; i < 4; ++i) { const bool up = (lane & 4) != 0; const float mine = up ? st[i + 4] : st[i], oth = up ? st[i] : st[i + 4]; st[i] = mine + __shfl_xor(oth, 4); }
#pragma unroll
    for (int i = 0; i < 2; ++i) { const bool up = (lane & 2) != 0; const float mine = up ? st[i + 2] : st[i], oth = up ? st[i] : st[i + 2]; st[i] = mine + __shfl_xor(oth, 2); }
    { const bool up = (lane & 1) != 0; const float mine = up ? st[1] : st[0], oth = up ? st[0] : st[1]; st[0] = mine + __shfl_xor(oth, 1); }
    LAS float* red = (LAS float*)(lds + CONV_RED_OFF); LAS float* stat = (LAS float*)(lds + CONV_STAT_OFF);
    red[wave * 64 + lane] = st[0];
    __syncthreads();
    if (tid < 32) { float s1 = 0.f, s2 = 0.f;
#pragma unroll
        for (int w = 0; w < 8; ++w) { s1 += red[w * 64 + tid]; s2 += red[w * 64 + 32 + tid]; }
        const float mu = s1 * (1.0f / 1024.0f), var = fmaxf(s2 * (1.0f / 1024.0f) - mu * mu, 0.f);
        stat[2 * tid] = mu; stat[2 * tid + 1] = 1.0f / sqrtf(var + EPS); }
    __syncthreads();
#pragma unroll
    for (int p = 0; p < 32; ++p) { const float mu = stat[2 * p], rs = stat[2 * p + 1];
        const float y0 = (a0[p] - mu) * rs * lg.x + lb.x, y1 = (a1[p] - mu) * rs * lg.y + lb.y;
        const float o0 = y0 * __builtin_amdgcn_rcpf(1.0f + __builtin_amdgcn_exp2f(-1.4426950408889634f * y0)), o1 = y1 * __builtin_amdgcn_rcpf(1.0f + __builtin_amdgcn_exp2f(-1.4426950408889634f * y1));
        *(GAS unsigned*)(MIX + (size_t)(row0 + p) * 2048 + 1024 + 2 * tid) = cvtpk2(o0, o1); }
}


__device__ __forceinline__ GAS void* karg(int idx) {
    const __attribute__((address_space(4))) unsigned long long* ka = (const __attribute__((address_space(4))) unsigned long long*)__builtin_amdgcn_kernarg_segment_ptr();
    asm volatile("" : "+s"(idx));
    return (GAS void*)ka[idx];
}
#define INP(i) ((const float*)(const GAS float*)karg(i))
#define OUTP ((float*)(GAS float*)karg(20))
#define WSP ((unsigned char*)(GAS unsigned char*)karg(21))
struct Args { const float* in[20]; float* out; unsigned char* ws; };

__global__ void __launch_bounds__(NWAVES * 64, 2) fwd_kernel(Args args) {
    extern __shared__ __attribute__((aligned(16))) unsigned char lds[];
    Frame F;
    F.lds = (LAS unsigned char*)lds;
    volatile LAS unsigned* MISC = (volatile LAS unsigned*)(F.lds + MISC_OFF);
    F.tid = threadIdx.x; F.lane = F.tid & 63; F.wave = __builtin_amdgcn_readfirstlane(F.tid >> 6);
    F.G = gridDim.x; { const int bx = blockIdx.x; F.vcu = (F.G % 8 == 0) ? (bx % 8) * (F.G / 8) + bx / 8 : bx; }
    (void)args;
    for (int u = F.tid; u < (LDS_BYTES - LDSCTL_OFF) / 4; u += NWAVES * 64) ((LAS unsigned*)(F.lds + LDSCTL_OFF))[u] = 0u;
    __syncthreads();
    (void)xcd_barrier_post((unsigned*)((gu32*)(WSP + WS_CTL) + CW_BAR), MISC + 8);
#define GRID_BAR() do { XcdBarrier b_; b_.bar = (unsigned*)((gu32*)(WSP + WS_CTL) + CW_BAR); b_.x = xb_xcc_id(); b_.st = (volatile LAS unsigned*)(F.lds + MISC_OFF) + 8; xcd_barrier(b_); } while (0)
    const int gw = F.vcu * NWAVES + F.wave, NGW = F.G * NWAVES;

    {
        unsigned char* ws = WSP; gu32* ctl = (gu32*)(ws + WS_CTL);
        LAS float* sil = (LAS float*)(F.lds + RING_OFF);
        LAS float* red = (LAS float*)(F.lds + RING_OFF + 40960);
        if ((int)blockIdx.x < DEPTH * 48) {
            const float* c_lat = INP(4); const float* c_ctx = INP(5); const float* w_mod = INP(7); const float* b_mod = INP(8); float* MOD = (float*)(ws + WS_MOD);
            for (int i = F.tid; i < 5 * 2048; i += NWAVES * 64) { const int ci = i >> 11, k = i & 2047; const float c = ci < 4 ? c_lat[ci * 2048 + k] : c_ctx[k]; sil[i] = c / (1.0f + __expf(-c)); }
            __syncthreads();
            for (int it = blockIdx.x; it < DEPTH * 48; it += F.G) {
                const int l = it / 48, cb = (it % 48) * 256;
                const float* wp = w_mod + ((size_t)l * 2048 + F.wave * 256) * NMODC + cb + F.lane * 4;
                f32x4 a[5];
#pragma unroll
                for (int ci = 0; ci < 5; ++ci) a[ci] = (f32x4){0.f, 0.f, 0.f, 0.f};
#pragma unroll 8
                for (int k = 0; k < 256; ++k) { const f32x4 w = *(const GAS f32x4*)(wp + (size_t)k * NMODC);
#pragma unroll
                    for (int ci = 0; ci < 5; ++ci) a[ci] += w * sil[ci * 2048 + F.wave * 256 + k]; }
#pragma unroll
                for (int ci = 0; ci < 5; ++ci) *(LAS f32x4*)(red + (F.wave * 5 + ci) * 256 + F.lane * 4) = a[ci];
                __syncthreads();
                for (int i = F.tid; i < 5 * 256; i += NWAVES * 64) { const int ci = i >> 8, c = i & 255; float s = b_mod[(size_t)l * NMODC + cb + c];
#pragma unroll
                    for (int w = 0; w < 8; ++w) s += red[(w * 5 + ci) * 256 + c];
                    MOD[((size_t)l * 5 + ci) * NMODC + cb + c] = s; }
                __syncthreads();
            }
        }
        { float* ROT = (float*)(ws + WS_ROT);
        for (int i = gw * 64 + F.lane; i < 1024 * 64; i += NGW * 64) { const int p = i >> 6, j = i & 63; const float pos = (float)(j < 32 ? (p >> 6) : (p & 63));
            const float fr = powf(10000.0f, -(float)(j & 31) / 32.0f); const float ang = pos * fr; ROT[i] = cosf(ang); ROT[65536 + i] = sinf(ang); } }
        { const float* cache_k = INP(2); const float* cache_v = INP(3); bf16* KL = (bf16*)(ws + WS_KL); bf16* VL = (bf16*)(ws + WS_VL);
        for (int i = gw * 64 + F.lane; i < 4 * DEPTH * PAST * 256 / 4; i += NGW * 64) {
            const int e = i * 4, col = e & 255, s = (e >> 8) & 511, l = (e >> 17) & 3, b = e >> 19;
            const f32x4 kx = *(const GAS f32x4*)(cache_k + e), vx = *(const GAS f32x4*)(cache_v + e);
            const size_t d = (((size_t)l * 4 + b) * KVL + 1024 + s) * 256 + col;
            *(GAS unsigned long long*)(KL + d) = (unsigned long long)cvtpk2(kx[0], kx[1]) | ((unsigned long long)cvtpk2(kx[2], kx[3]) << 32);
            *(GAS unsigned long long*)(VL + d) = (unsigned long long)cvtpk2(vx[0], vx[1]) | ((unsigned long long)cvtpk2(vx[2], vx[3]) << 32);
        } }
        {
            const float* w_in = INP(9); const float* w_out = INP(16); const float* w_ff1 = INP(18); const float* w_ff2 = INP(19);
            bf16* Win_t = (bf16*)(ws + WS_WIN); bf16* Wout_t = (bf16*)(ws + WS_WOUT); bf16* W1_t = (bf16*)(ws + WS_W1); bf16* W2_t = (bf16*)(ws + WS_W2);
            LAS float* scr = (LAS float*)(F.lds + RING_OFF + F.wave * 8704);
            constexpr int I_IN = (DM / 64) * (INC / 32), I_OUT = (DM / 64) * (DM / 32), I_1 = (DM / 64) * (DFF / 32), I_2 = (DFF / 64) * (DM / 32), I_L = I_IN + I_OUT + I_1 + I_2, NITEMS = DEPTH * I_L;
            for (;;) {
                int base = 0; if (F.lane == 0) base = (int)__hip_atomic_fetch_add(ctl + CW_CVT, 16u, __ATOMIC_RELAXED, __HIP_MEMORY_SCOPE_AGENT);
                base = __builtin_amdgcn_readfirstlane(base);
                if (base >= NITEMS) break;
                for (int it = base; it < base + 16 && it < NITEMS; ++it) {
                    const int l = it / I_L; int r = it % I_L;
                    if (r < I_IN) { const int nblk = INC / 32, kb = r / nblk, nb = r % nblk; transpose_item(w_in + (size_t)l * DM * INC, DM, INC, Win_t + (size_t)l * INC * DM, 64 * kb, 32 * nb, win_dest_row(32 * nb), scr, F.lane); continue; } r -= I_IN;
                    if (r < I_OUT) { const int nblk = DM / 32, kb = r / nblk, nb = r % nblk; transpose_item(w_out + (size_t)l * DM * DM, DM, DM, Wout_t + (size_t)l * DM * DM, 64 * kb, 32 * nb, 32 * nb, scr, F.lane); continue; } r -= I_OUT;
                    if (r < I_1) { const int nblk = DFF / 32, kb = r / nblk, nb = r % nblk; transpose_item(w_ff1 + (size_t)l * DM * DFF, DM, DFF, W1_t + (size_t)l * DFF * DM, 64 * kb, 32 * nb, 32 * nb, scr, F.lane); continue; } r -= I_1;
                    { const int nblk = DM / 32, kb = r / nblk, nb = r % nblk; transpose_item(w_ff2 + (size_t)l * DFF * DM, DFF, DM, W2_t + (size_t)l * DM * DFF, 64 * kb, 32 * nb, 32 * nb, scr, F.lane); }
                }
            }
        }
    }
    GRID_BAR();

    for (int l = 0; l < DEPTH; ++l) {
#define WS_(off) (WSP + (off))
#define MODL ((const float*)WS_(WS_MOD) + (size_t)l * 5 * NMODC)
#define YP OUTP
#define XC (l == 0 ? INP(0) : (const float*)YP)
#define XL (l == 0 ? INP(1) : (const float*)YP + (size_t)NCTX * DM)
#define KLL ((bf16*)WS_(WS_KL) + (size_t)l * 4 * KVL * 256)
#define VLL ((bf16*)WS_(WS_VL) + (size_t)l * 4 * KVL * 256)

        norm_rows(gw, NGW, F.lane, XC, XL, INP(6) + (size_t)l * DM, MODL, 0, 1, (bf16*)WS_(WS_XN));
        GRID_BAR();

#ifndef NO_L2
        {
            unsigned char* ws = WSP; pg8::Gemm g{(bf16*)(ws + WS_XN), (bf16*)(ws + WS_WIN) + (size_t)l * INC * DM, M, INC, DM}; pg8::StaticOrder S; { int Gq = F.G; asm volatile("" : "+s"(Gq)); S.init(M, INC, Gq, (int)blockIdx.x); }
            pg8::EpiProj E{(bf16*)(ws + WS_Q), (bf16*)(ws + WS_KR), (bf16*)(ws + WS_VC), (bf16*)(ws + WS_VL) + (size_t)l * 4 * KVL * 256, (bf16*)(ws + WS_GLU), OUTP + (size_t)M * DM + (size_t)NCTX * DEPTH * 256, l};
            pg8::gemm_phase<pg8::EpiProj, pg8::StaticOrder, true, true>(F.lds + RING_OFF, g, S, E);
        }
#endif
        GRID_BAR();

        { unsigned char* ws = WSP; knorm_rows(gw, NGW, F.lane, (const bf16*)(ws + WS_KR), INP(11) + (size_t)l * 128, (const float*)(ws + WS_ROT), OUTP + (size_t)M * DM, l, (bf16*)(ws + WS_KC), (bf16*)(ws + WS_KL) + (size_t)l * 4 * KVL * 256); }
        GRID_BAR();

        {
            char* al = (char*)lds + RING_OFF;
            unsigned char* ws = WSP; const bf16* QB = (const bf16*)(ws + WS_Q); const bf16* KC = (const bf16*)(ws + WS_KC); const bf16* VC = (const bf16*)(ws + WS_VC); const bf16* KLl = (const bf16*)(ws + WS_KL) + (size_t)l * 4 * KVL * 256; const bf16* VLl = (const bf16*)(ws + WS_VL) + (size_t)l * 4 * KVL * 256;
            bf16* MIX = (bf16*)(ws + WS_MIX); const float* ROT = (const float*)(ws + WS_ROT); const float* q_norm_g = INP(10);
#ifndef NO_ATTN
            for (int u = F.vcu; u < 256; u += F.G) {
                if (u < 128) {
                    const int bk = u >> 4, b = bk >> 1, kvh = bk & 1, h = kvh * 4 + ((u >> 2) & 3), qb = u & 3;
                    const size_t row0 = (size_t)NCTX + b * 1024 + qb * 256;
                    att::attn_unit(QB + row0 * 1024 + h * 128, q_norm_g + (size_t)l * 128, ROT + (size_t)(qb * 256) * 64, KLl + (size_t)b * KVL * 256 + kvh * 128, VLl + (size_t)b * KVL * 256 + kvh * 128,
                                   MIX + row0 * 2048 + h * 128, KVL, al);
                } else {
                    const int j = u - 128, b = j >> 3, h = j & 7; const size_t row0 = (size_t)b * 256;
                    att::attn_unit(QB + row0 * 1024 + h * 128, q_norm_g + (size_t)l * 128, nullptr, KC + row0 * 256 + (h >> 2) * 128, VC + row0 * 256 + (h >> 2) * 128,
                                   MIX + row0 * 2048 + h * 128, 256, al);
                }
            }
#endif
            for (int i = 0;; ++i) {
                int c;
                if (F.G == 256) { if (F.vcu < 128 || i >= 2) break; c = 2 * (F.vcu - 128) + i; }
                else { c = F.vcu + i * F.G; if (c >= 256) break; }
#ifndef NO_CONV
                conv_unit(c, F.lds + RING_OFF, F.tid, (const bf16*)(ws + WS_GLU), INP(12) + (size_t)l * 31 * 1024, INP(13) + (size_t)l * 1024, INP(14) + (size_t)l * 1024, INP(15) + (size_t)l * 1024, MIX);
#endif
                __syncthreads();
            }
        }
        GRID_BAR();

#ifndef NO_L4
        {
            unsigned char* ws = WSP; pg8::Gemm g{(bf16*)(ws + WS_MIX), (bf16*)(ws + WS_WOUT) + (size_t)l * DM * DM, M, DM, DM}; pg8::StaticOrder S; { int Gq = F.G; asm volatile("" : "+s"(Gq)); S.init(M, DM, Gq, (int)blockIdx.x); }
            pg8::EpiRes E{XC, XL, YP, (const float*)(ws + WS_MOD) + (size_t)l * 5 * NMODC + 2 * 2048};
            pg8::gemm_phase<pg8::EpiRes, pg8::StaticOrder, true, true>(F.lds + RING_OFF, g, S, E);
        }
#endif
        GRID_BAR();

        { float* y = YP; norm_rows(gw, NGW, F.lane, y, y + (size_t)NCTX * DM, INP(17) + (size_t)l * DM, MODL, 3, 4, (bf16*)WS_(WS_XN)); }
        GRID_BAR();

#ifndef NO_L6
        {
            unsigned char* ws = WSP; pg8::Gemm g{(bf16*)(ws + WS_XN), (bf16*)(ws + WS_W1) + (size_t)l * DFF * DM, M, DFF, DM}; pg8::StaticOrder S; { int Gq = F.G; asm volatile("" : "+s"(Gq)); S.init(M, DFF, Gq, (int)blockIdx.x); }
            pg8::EpiFF1 E{(bf16*)(ws + WS_H)};
            pg8::gemm_phase<pg8::EpiFF1, pg8::StaticOrder, true, true>(F.lds + RING_OFF, g, S, E);
        }
#endif
        GRID_BAR();

#ifndef NO_L7
        {
            unsigned char* ws = WSP; pg8::Gemm g{(bf16*)(ws + WS_H), (bf16*)(ws + WS_W2) + (size_t)l * DM * DFF, M, DM, DFF}; pg8::StaticOrder S; { int Gq = F.G; asm volatile("" : "+s"(Gq)); S.init(M, DM, Gq, (int)blockIdx.x); }
            float* y = YP; pg8::EpiRes E{y, y + (size_t)NCTX * DM, y, (const float*)(ws + WS_MOD) + (size_t)l * 5 * NMODC + 5 * 2048};
            pg8::gemm_phase<pg8::EpiRes, pg8::StaticOrder, true, true>(F.lds + RING_OFF, g, S, E);
        }
#endif
        if (l + 1 < DEPTH) GRID_BAR();
    }
}

extern "C" void kernel_launch(void* const* d_in, const int* in_sizes, int n_in, void* d_out, int out_size, void* d_ws, size_t ws_size, hipStream_t stream) {
    static int grid = 0;
    if (grid == 0) {
        if (n_in != 20 || ws_size < WS_END) { fprintf(stderr, "kernel_launch: built for 20 inputs and >= %zu bytes of workspace; got n_in %d, ws %zu; nothing launched\n", (size_t)WS_END, n_in, ws_size); grid = -1; return; }
        int dev = 0, cus = 0, per_cu = 0;
        if (hipGetDevice(&dev) != hipSuccess || hipDeviceGetAttribute(&cus, hipDeviceAttributeMultiprocessorCount, dev) != hipSuccess) { fprintf(stderr, "kernel_launch: device query failed\n"); grid = -1; return; }
        if (hipFuncSetAttribute((const void*)fwd_kernel, hipFuncAttributeMaxDynamicSharedMemorySize, LDS_BYTES) != hipSuccess) { fprintf(stderr, "kernel_launch: hipFuncSetAttribute failed\n"); grid = -1; return; }
        if (hipOccupancyMaxActiveBlocksPerMultiprocessor(&per_cu, (const void*)fwd_kernel, NWAVES * 64, LDS_BYTES) != hipSuccess || per_cu < 1) { fprintf(stderr, "kernel_launch: occupancy query reports %d workgroups per CU\n", per_cu); }
        (void)hipGetLastError();
        grid = cus;
    }
    if (grid < 0) return;
    if (hipMemsetAsync((char*)d_ws + WS_CTL, 0, CTL_ZERO_BYTES, stream) != hipSuccess) { fprintf(stderr, "kernel_launch: hipMemsetAsync failed\n"); return; }
    Args a{};
    for (int i = 0; i < 20; ++i) a.in[i] = (const float*)d_in[i];
    a.out = (float*)d_out; a.ws = (unsigned char*)d_ws;
    hipLaunchKernelGGL(fwd_kernel, dim3(grid), dim3(NWAVES * 64), LDS_BYTES, stream, a);
    const hipError_t le = hipPeekAtLastError();
    if (le != hipSuccess) fprintf(stderr, "kernel_launch: launch failed: %s\n", hipGetErrorName(le));
}
```
